# Optimizing an MI355X kernel written in HIP

```python
import jax, jax.numpy as jnp
from jax import lax
import numpy as np

D_MODEL = 1024
BATCH = 2
SEQ = 8192
DEPTH = 1
DEC_BATCH = 16
DEC_SEQ = 32
PAST_LEN = 4096

CHUNK = 64
D_CONV = D_MODEL // 2
D_POOL = D_MODEL // 2
CONV_WIDTH = 31
CONV_HIST = CONV_WIDTH - 1
POOL_WINDOWS = (2, 4, 8, 16)
N_POOL_GROUPS = len(POOL_WINDOWS)
POOL_GROUP = D_POOL // N_POOL_GROUPS
POOL_HIST = max(POOL_WINDOWS) - 1
D_IN = 2 * D_CONV + D_POOL
D_FF = ((8 * D_MODEL // 3 + 127) // 128) * 128
ALPHA = (2.0 * DEPTH) ** 0.25
BETA = (8.0 * DEPTH) ** -0.25
LN_EPS = 1e-5

kernel_name = "streaming_conv_pool_hybrid_step"


def layer_norm(x, g, b):
    xf = x.astype(jnp.float32)
    mu = jnp.mean(xf, axis=-1, keepdims=True)
    var = jnp.mean(jnp.square(xf - mu), axis=-1, keepdims=True)
    y = (xf - mu) * lax.rsqrt(var + LN_EPS)
    return (y * g.astype(jnp.float32) + b.astype(jnp.float32)).astype(x.dtype)


def swiglu(x, w_g, w_u, w_d):
    return (jax.nn.silu(x @ w_g) * (x @ w_u)) @ w_d


def causal_depthwise_conv(ext, w, b):
    c = ext.shape[-1]
    out = lax.conv_general_dilated(ext, w[:, None, :].astype(ext.dtype), window_strides=(1,),
                                   padding="VALID", dimension_numbers=("NWC", "WIO", "NWC"),
                                   feature_group_count=c)
    return out + b


def multiscale_pool(ext, pos0):
    L = ext.shape[1] - POOL_HIST
    xf = ext.astype(jnp.float32)
    cs = jnp.concatenate([jnp.zeros_like(xf[:, :1]), jnp.cumsum(xf, axis=1)], axis=1)
    end = cs[:, POOL_HIST + 1:]
    pos = pos0 + jnp.arange(L, dtype=jnp.int32)
    outs = []
    for gi, w in enumerate(POOL_WINDOWS):
        sl = slice(gi * POOL_GROUP, (gi + 1) * POOL_GROUP)
        start = cs[:, POOL_HIST + 1 - w: POOL_HIST + 1 - w + L, sl]
        cnt = jnp.minimum(pos + 1, w).astype(jnp.float32)[None, :, None]
        outs.append((end[..., sl] - start) / cnt)
    mean = jnp.concatenate(outs, axis=-1)
    return mean - xf[:, POOL_HIST:]


def encoder_layer(x, conv_prev, pool_prev, pos0,
                  w_ffn1_gate, w_ffn1_up, w_ffn1_down, ln1_g, ln1_b,
                  w_in, w_gate, b_gate, conv_w, conv_b, conv_ln_g, conv_ln_b, w_conv_proj,
                  w_pool_group, pool_scale, w_pool_proj, w_out, ln2_g, ln2_b,
                  w_ffn2_gate, w_ffn2_up, w_ffn2_down, ln3_g, ln3_b):
    h = layer_norm(ALPHA * x + 0.5 * swiglu(x, w_ffn1_gate, w_ffn1_up, w_ffn1_down), ln1_g, ln1_b)

    u = h @ w_in
    conv_a = u[..., :D_CONV]
    conv_b_ = u[..., D_CONV:2 * D_CONV]
    pool_in = u[..., 2 * D_CONV:]

    glu = conv_a * jax.nn.sigmoid(conv_b_)
    conv_ext = jnp.concatenate([conv_prev.astype(glu.dtype), glu], axis=1)
    dc = causal_depthwise_conv(conv_ext, conv_w, conv_b)
    branch_conv = jax.nn.silu(layer_norm(dc, conv_ln_g, conv_ln_b)) @ w_conv_proj

    pool_ext = jnp.concatenate([pool_prev.astype(pool_in.dtype), pool_in], axis=1)
    pooled = multiscale_pool(pool_ext, pos0).astype(pool_in.dtype)
    Bsz, L = pooled.shape[0], pooled.shape[1]
    pg = pooled.reshape(Bsz, L, N_POOL_GROUPS, POOL_GROUP)
    pg = jnp.einsum("blgc,gcd->blgd", pg, w_pool_group).reshape(Bsz, L, D_POOL)
    branch_pool = (pg * pool_scale) @ w_pool_proj

    gates = jax.nn.sigmoid(h @ w_gate + b_gate)
    g_conv = gates[..., :D_MODEL]
    g_pool = gates[..., D_MODEL:]
    mixed = (g_conv * branch_conv + g_pool * branch_pool) @ w_out
    h2 = layer_norm(ALPHA * h + mixed, ln2_g, ln2_b)

    y = layer_norm(ALPHA * h2 + 0.5 * swiglu(h2, w_ffn2_gate, w_ffn2_up, w_ffn2_down), ln3_g, ln3_b)
    return y, conv_ext[:, -CONV_HIST:], pool_ext[:, -POOL_HIST:]


def setup_inputs(seed: int = 0) -> dict:
    key = jax.random.key(seed)
    ks = iter(jax.random.split(key, 40))

    def nrm(shape, scale):
        return jax.random.normal(next(ks), shape, jnp.float32) * scale

    def gain(shape):
        return 1.0 + nrm(shape, 0.02)

    L = DEPTH
    return {
        "x_prompt": nrm((BATCH, SEQ, D_MODEL), 1.0),
        "x_sample": nrm((DEC_BATCH, DEC_SEQ, D_MODEL), 1.0),
        "state_conv": nrm((L, DEC_BATCH, CONV_HIST, D_CONV), 0.5),
        "state_pool": nrm((L, DEC_BATCH, POOL_HIST, D_POOL), 1.0),
        "w_ffn1_gate": nrm((L, D_MODEL, D_FF), D_MODEL ** -0.5),
        "w_ffn1_up": nrm((L, D_MODEL, D_FF), D_MODEL ** -0.5),
        "w_ffn1_down": nrm((L, D_FF, D_MODEL), BETA * D_FF ** -0.5),
        "ln1_g": gain((L, D_MODEL)),
        "ln1_b": nrm((L, D_MODEL), 0.02),
        "w_in": nrm((L, D_MODEL, D_IN), D_MODEL ** -0.5),
        "w_gate": nrm((L, D_MODEL, 2 * D_MODEL), D_MODEL ** -0.5),
        "b_gate": nrm((L, 2 * D_MODEL), 0.02),
        "conv_w": nrm((L, CONV_WIDTH, D_CONV), CONV_WIDTH ** -0.5),
        "conv_b": nrm((L, D_CONV), 0.02),
        "conv_ln_g": gain((L, D_CONV)),
        "conv_ln_b": nrm((L, D_CONV), 0.02),
        "w_conv_proj": nrm((L, D_CONV, D_MODEL), D_CONV ** -0.5),
        "w_pool_group": nrm((L, N_POOL_GROUPS, POOL_GROUP, POOL_GROUP), POOL_GROUP ** -0.5),
        "pool_scale": 1.0 + nrm((L, D_POOL), 0.1),
        "w_pool_proj": nrm((L, D_POOL, D_MODEL), D_POOL ** -0.5),
        "w_out": nrm((L, D_MODEL, D_MODEL), BETA * D_MODEL ** -0.5),
        "ln2_g": gain((L, D_MODEL)),
        "ln2_b": nrm((L, D_MODEL), 0.02),
        "w_ffn2_gate": nrm((L, D_MODEL, D_FF), D_MODEL ** -0.5),
        "w_ffn2_up": nrm((L, D_MODEL, D_FF), D_MODEL ** -0.5),
        "w_ffn2_down": nrm((L, D_FF, D_MODEL), BETA * D_FF ** -0.5),
        "ln3_g": gain((L, D_MODEL)),
        "ln3_b": nrm((L, D_MODEL), 0.02),
    }


def reference(x_prompt, x_sample, state_conv, state_pool,
              w_ffn1_gate, w_ffn1_up, w_ffn1_down, ln1_g, ln1_b,
              w_in, w_gate, b_gate, conv_w, conv_b, conv_ln_g, conv_ln_b, w_conv_proj,
              w_pool_group, pool_scale, w_pool_proj, w_out, ln2_g, ln2_b,
              w_ffn2_gate, w_ffn2_up, w_ffn2_down, ln3_g, ln3_b):
    hp = x_prompt
    hs = x_sample
    conv_p_list, conv_s_list, pool_p_list, pool_s_list = [], [], [], []
    for l in range(DEPTH):
        weights = (w_ffn1_gate[l], w_ffn1_up[l], w_ffn1_down[l], ln1_g[l], ln1_b[l],
                   w_in[l], w_gate[l], b_gate[l], conv_w[l], conv_b[l], conv_ln_g[l], conv_ln_b[l],
                   w_conv_proj[l], w_pool_group[l], pool_scale[l], w_pool_proj[l], w_out[l],
                   ln2_g[l], ln2_b[l], w_ffn2_gate[l], w_ffn2_up[l], w_ffn2_down[l], ln3_g[l], ln3_b[l])
        zero_conv = jnp.zeros((hp.shape[0], CONV_HIST, D_CONV), hp.dtype)
        zero_pool = jnp.zeros((hp.shape[0], POOL_HIST, D_POOL), hp.dtype)
        hp, cp, pp = encoder_layer(hp, zero_conv, zero_pool, 0, *weights)
        hs, cs_, ps_ = encoder_layer(hs, state_conv[l], state_pool[l], PAST_LEN, *weights)
        conv_p_list.append(cp)
        conv_s_list.append(cs_)
        pool_p_list.append(pp)
        pool_s_list.append(ps_)
    new_conv_prompt = jnp.stack(conv_p_list, axis=0)
    new_conv_sample = jnp.stack(conv_s_list, axis=0)
    new_pool_prompt = jnp.stack(pool_p_list, axis=0)
    new_pool_sample = jnp.stack(pool_s_list, axis=0)
    return (hp, hs, new_conv_prompt, new_conv_sample, new_pool_prompt, new_pool_sample)
```

```cpp
#include <hip/hip_runtime.h>
#include <cstdio>
#include <cstdint>
namespace pg8 {
#define PG8_LAS __attribute__((address_space(3)))
typedef unsigned short bf16_t;
typedef short bf16x8 __attribute__((ext_vector_type(8)));
typedef float f32x4 __attribute__((ext_vector_type(4)));
typedef unsigned u32x4 __attribute__((ext_vector_type(4)));
constexpr int BM = 256, BK = 64, HALF = 128, HTB = HALF * BK * 2  , STAGE_BYTES = 8 * HTB, NXCD = 8, WGM = 8;

__host__ __device__ __forceinline__ int lds_byte(int r, int c) { const int st = (r >> 4) * 2 + (c >> 5), rr = r & 15, cc = c & 31, ob = rr * 64 + cc * 2; return st * 1024 + (ob ^ (((ob >> 9) & 1) << 5)); }
__host__ __device__ __forceinline__ void stage_rc(int b, int& R, int& C) { const int st = b / 1024, sb = b % 1024, swz = sb ^ (((sb >> 9) & 1) << 5); R = (st >> 1) * 16 + swz / 64; C = (st & 1) * 32 + (swz % 64) / 2; }
__host__ __device__ __forceinline__ int perm32(int rho) { const int n = rho >> 4, i = rho & 15; return 8 * (i >> 2) + 4 * n + (i & 3); }

struct Unit { int pm, pn; };
struct Gemm { const bf16_t* A; const bf16_t* Bt; int M, N, K; };

struct StaticOrder {
    int nM, nN, nwg, G, c;
    __host__ __device__ void init(int M, int N, int G_, int c_) { nM = M / BM; nN = N / BM; nwg = nM * nN; G = G_; c = c_; }
    __host__ __device__ bool next(int i, Unit& u) const {
        const long L = (long)i * G + c; if (L >= nwg) return false;
        int wgid = (int)L; { const int q = nwg / NXCD, r = nwg % NXCD, xcd = wgid % NXCD, off = wgid / NXCD; wgid = (xcd < r ? xcd * (q + 1) : r * (q + 1) + (xcd - r) * q) + off; }
        const int nig = WGM * nN, gid = wgid / nig, fm = gid * WGM, gsz = (nM - fm) < WGM ? (nM - fm) : WGM;
        u.pm = fm + ((wgid % nig) % gsz); u.pn = (wgid % nig) / gsz; return true;
    }
    __device__ __forceinline__ void a_ready(const Unit&) const {}
    __device__ __forceinline__ void done(const Unit&) const {}
};

typedef float f32x2c_t __attribute__((ext_vector_type(2))); typedef __bf16 bf16x2c_t __attribute__((ext_vector_type(2)));
__device__ __forceinline__ unsigned cvt_pk_bf16(float lo, float hi) { const f32x2c_t v = {lo, hi}; const bf16x2c_t b = __builtin_convertvector(v, bf16x2c_t); return __builtin_bit_cast(unsigned, b); }
__device__ __forceinline__ float fsigmoid(float z) { return __builtin_amdgcn_rcpf(1.0f + __builtin_amdgcn_exp2f(-1.4426950408889634f * z)); }
__device__ __forceinline__ f32x4 sigmoid4(f32x4 z) { f32x4 r; r[0] = fsigmoid(z[0]); r[1] = fsigmoid(z[1]); r[2] = fsigmoid(z[2]); r[3] = fsigmoid(z[3]); return r; }
__device__ __forceinline__ u32x4 pack8(f32x4 v0, f32x4 v1) { u32x4 w; w.x = cvt_pk_bf16(v0[0], v0[1]); w.y = cvt_pk_bf16(v0[2], v0[3]); w.z = cvt_pk_bf16(v1[0], v1[1]); w.w = cvt_pk_bf16(v1[2], v1[3]); return w; }
__device__ __forceinline__ void unpack8(u32x4 w, f32x4& v0, f32x4& v1) {
    v0[0] = __uint_as_float(w.x << 16); v0[1] = __uint_as_float(w.x & 0xffff0000u); v0[2] = __uint_as_float(w.y << 16); v0[3] = __uint_as_float(w.y & 0xffff0000u);
    v1[0] = __uint_as_float(w.z << 16); v1[1] = __uint_as_float(w.z & 0xffff0000u); v1[2] = __uint_as_float(w.w << 16); v1[3] = __uint_as_float(w.w & 0xffff0000u); }

__device__ __forceinline__ void store16_sc1(void* p, u32x4 v) { asm volatile("global_store_dwordx4 %0, %1, off sc1\n\ts_nop 1" :: "v"(p), "v"(v) : "memory"); }
struct EpiGU {
    static constexpr bool PERM = true, AFTER_DRAIN = false;
    bf16_t* H; int ldh;
    __device__ __forceinline__ void operator()(f32x4 (&acc)[2][2][4][2], const Unit& u, int wr, int wc, int fr, int fq) const {
        const int row0 = u.pm * BM + wr * 64 + fr, col0 = u.pn * HALF + wc * 32 + 8 * fq;
#pragma unroll
        for (int ai = 0; ai < 2; ++ai)
#pragma unroll
            for (int m = 0; m < 4; ++m) { bf16_t* p = H + (size_t)(row0 + ai * HALF + m * 16) * ldh + col0;
                const f32x4 g0 = acc[ai][0][m][0], g1 = acc[ai][0][m][1];
                const f32x4 v0 = g0 * sigmoid4(g0) * acc[ai][1][m][0], v1 = g1 * sigmoid4(g1) * acc[ai][1][m][1];
                *(u32x4*)p = pack8(v0, v1); }
    }
};
struct EpiF32 {
    static constexpr bool PERM = true, AFTER_DRAIN = false;
    float* C; int ldc;
    __device__ __forceinline__ void operator()(f32x4 (&acc)[2][2][4][2], const Unit& u, int wr, int wc, int fr, int fq) const {
        const int row0 = u.pm * BM + wr * 64 + fr, col0 = u.pn * BM + wc * 32 + 8 * fq;
#pragma unroll
        for (int ai = 0; ai < 2; ++ai)
#pragma unroll
            for (int m = 0; m < 4; ++m) { float* p = C + (size_t)(row0 + ai * HALF + m * 16) * ldc + col0;
#pragma unroll
                for (int bj = 0; bj < 2; ++bj)
#pragma unroll
                    for (int n = 0; n < 2; ++n) *(f32x4*)(p + bj * HALF + 4 * n) = acc[ai][bj][m][n]; }
    }
};
struct EpiB16 {
    static constexpr bool PERM = true, AFTER_DRAIN = false;
    bf16_t* O; int ldc;
    __device__ __forceinline__ void operator()(f32x4 (&acc)[2][2][4][2], const Unit& u, int wr, int wc, int fr, int fq) const {
        const int row0 = u.pm * BM + wr * 64 + fr, col0 = u.pn * BM + wc * 32 + 8 * fq;
#pragma unroll
        for (int ai = 0; ai < 2; ++ai)
#pragma unroll
            for (int m = 0; m < 4; ++m) { bf16_t* p = O + (size_t)(row0 + ai * HALF + m * 16) * ldc + col0;
#pragma unroll
                for (int bj = 0; bj < 2; ++bj) *(u32x4*)(p + bj * HALF) = pack8(acc[ai][bj][m][0], acc[ai][bj][m][1]); }
    }
};
struct EpiIG {
    static constexpr bool PERM = true, AFTER_DRAIN = false;
    float* glu; float* pin; bf16_t* gates; const float* bgate;
    __device__ __forceinline__ void operator()(f32x4 (&acc)[2][2][4][2], const Unit& u, int wr, int wc, int fr, int fq) const {
        const int row0 = u.pm * BM + wr * 64 + fr;
        if (u.pn < 4) {
            const int col0 = u.pn * HALF + wc * 32 + 8 * fq;
#pragma unroll
            for (int ai = 0; ai < 2; ++ai)
#pragma unroll
                for (int m = 0; m < 4; ++m) { float* p = glu + (size_t)(row0 + ai * HALF + m * 16) * 512 + col0;
#pragma unroll
                    for (int n = 0; n < 2; ++n) *(f32x4*)(p + 4 * n) = acc[ai][0][m][n] * sigmoid4(acc[ai][1][m][n]); }
        } else if (u.pn < 6) {
            const int col0 = (u.pn - 4) * BM + wc * 32 + 8 * fq;
#pragma unroll
            for (int ai = 0; ai < 2; ++ai)
#pragma unroll
                for (int m = 0; m < 4; ++m) { float* p = pin + (size_t)(row0 + ai * HALF + m * 16) * 512 + col0;
#pragma unroll
                    for (int bj = 0; bj < 2; ++bj)
#pragma unroll
                        for (int n = 0; n < 2; ++n) *(f32x4*)(p + bj * HALF + 4 * n) = acc[ai][bj][m][n]; }
        } else {
            const int col0 = (u.pn - 6) * BM + wc * 32 + 8 * fq;
            f32x4 bv[2][2];
#pragma unroll
            for (int bj = 0; bj < 2; ++bj)
#pragma unroll
                for (int n = 0; n < 2; ++n) bv[bj][n] = *(const f32x4*)(bgate + col0 + bj * HALF + 4 * n);
#pragma unroll
            for (int ai = 0; ai < 2; ++ai)
#pragma unroll
                for (int m = 0; m < 4; ++m) { bf16_t* p = gates + (size_t)(row0 + ai * HALF + m * 16) * 2048 + col0;
#pragma unroll
                    for (int bj = 0; bj < 2; ++bj) {
#ifdef DBG_NOBIAS
                        *(u32x4*)(p + bj * HALF) = pack8(acc[ai][bj][m][0], acc[ai][bj][m][1]);
#else
                        *(u32x4*)(p + bj * HALF) = pack8(sigmoid4(acc[ai][bj][m][0] + bv[bj][0]), sigmoid4(acc[ai][bj][m][1] + bv[bj][1]));
#endif
                    } }
        }
    }
};
template <int MODE> struct EpiGate {
    static constexpr bool PERM = true, AFTER_DRAIN = false;
    bf16_t* X; const bf16_t* gates; int goff;
    __device__ __forceinline__ void operator()(f32x4 (&acc)[2][2][4][2], const Unit& u, int wr, int wc, int fr, int fq) const {
        const int row0 = u.pm * BM + wr * 64 + fr, col0 = u.pn * BM + wc * 32 + 8 * fq;
#pragma unroll
        for (int ai = 0; ai < 2; ++ai)
#pragma unroll
            for (int m = 0; m < 4; ++m) { const size_t r = (size_t)(row0 + ai * HALF + m * 16);
#pragma unroll
                for (int bj = 0; bj < 2; ++bj) { f32x4 g0, g1; unpack8(*(const u32x4*)(gates + r * 2048 + goff + col0 + bj * HALF), g0, g1);
                    f32x4 v0 = g0 * acc[ai][bj][m][0], v1 = g1 * acc[ai][bj][m][1];
                    bf16_t* p = X + r * 1024 + col0 + bj * HALF;
                    if (MODE == 1) { f32x4 o0, o1; unpack8(*(const u32x4*)p, o0, o1); v0 += o0; v1 += o1; }
                    *(u32x4*)p = pack8(v0, v1); } }
    }
};

template <class Epi, class Sched, bool ALIGN_EPI = false, bool SP2 = false>
__device__ __forceinline__ void gemm_phase(PG8_LAS unsigned char* lds, const Gemm g, const Sched& S, const Epi& E) {
    const int tid = threadIdx.x, wid = __builtin_amdgcn_readfirstlane(tid >> 6), lane = tid & 63, wr = wid >> 2, wc = wid & 3, fr = lane & 15, fq = lane >> 4;
    const int K = g.K, nt = K / BK;
    unsigned voffA[2], voffB[2];
#pragma unroll
    for (int i = 0; i < 2; ++i) { int R, C; stage_rc(tid * 16 + i * 8192, R, C); const int Rb = Epi::PERM ? ((R & ~31) + perm32(R & 31)) : R;
        voffA[i] = (unsigned)(R * K + C) * 2u; voffB[i] = (unsigned)(Rb * K + C) * 2u; }
    const size_t kstep = (size_t)(BK * 2);
    const size_t hstep = (size_t)HALF * K * 2;
    const size_t tstep = 2 * hstep;
    const unsigned ldsw = (unsigned)wid * 1024u;
    const int aoff = lds_byte(wr * 64 + fr, fq * 8), boff = lds_byte(wc * 32 + fr, fq * 8);
#define PG8_SA(b, h) (((b) * 2 + (h)) * HTB)
#define PG8_SB(b, h) ((4 + (b) * 2 + (h)) * HTB)
#define PG8_STAGE(bufoff, gbase, voff) do { _Pragma("unroll") for (int _i = 0; _i < 2; ++_i) \
        __builtin_amdgcn_global_load_lds((const unsigned*)((const char*)(gbase) + (voff)[_i]), (PG8_LAS unsigned*)(lds + (bufoff) + ldsw + _i * 8192), 16, 0, 0); } while (0)
#define PG8_LDA(dst, b, h) do { _Pragma("unroll") for (int m = 0; m < 4; ++m) _Pragma("unroll") for (int k = 0; k < 2; ++k) dst[m][k] = *(const PG8_LAS bf16x8*)(lds + PG8_SA(b, h) + aoff + m * 2048 + k * 1024); } while (0)
#define PG8_LDB(dst, b, h) do { _Pragma("unroll") for (int n = 0; n < 2; ++n) _Pragma("unroll") for (int k = 0; k < 2; ++k) dst[n][k] = *(const PG8_LAS bf16x8*)(lds + PG8_SB(b, h) + boff + n * 2048 + k * 1024); } while (0)
#define PG8_MMA(ai, bj, At, Bt) do { __builtin_amdgcn_s_setprio(1); _Pragma("unroll") for (int m = 0; m < 4; ++m) _Pragma("unroll") for (int n = 0; n < 2; ++n) _Pragma("unroll") for (int k = 0; k < 2; ++k) \
        acc[ai][bj][m][n] = __builtin_amdgcn_mfma_f32_16x16x32_bf16(Bt[n][k], At[m][k], acc[ai][bj][m][n], 0, 0, 0); __builtin_amdgcn_s_setprio(0); } while (0)
#define PG8_WAIT_V(n) asm volatile("s_waitcnt vmcnt(" #n ")" ::: "memory")
#define PG8_WAIT_L(n) asm volatile("s_waitcnt lgkmcnt(" #n ")" ::: "memory")
#define PG8_BAR __builtin_amdgcn_s_barrier()
#define PG8_SCHED __builtin_amdgcn_sched_barrier(0)
    Unit cur, nxt; int ui = 0;
    if (!S.next(0, cur)) return;
    f32x4 acc[2][2][4][2];
#pragma unroll
    for (int a = 0; a < 2; ++a)
#pragma unroll
        for (int b = 0; b < 2; ++b)
#pragma unroll
            for (int m = 0; m < 4; ++m)
#pragma unroll
                for (int n = 0; n < 2; ++n) acc[a][b][m][n] = (f32x4){0.f, 0.f, 0.f, 0.f};
    bf16x8 At[4][2], B0[2][2], B1[2][2];
    const char* cA = (const char*)g.A + (size_t)cur.pm * tstep; const char* cB = (const char*)g.Bt + (size_t)cur.pn * tstep;
    S.a_ready(cur);
    if constexpr (SP2) {
        PG8_STAGE(PG8_SB(0, 0), cB, voffB); PG8_STAGE(PG8_SB(0, 1), cB + hstep, voffB); PG8_STAGE(PG8_SA(0, 0), cA, voffA); PG8_STAGE(PG8_SA(0, 1), cA + hstep, voffA);
        if (wr == 1) PG8_BAR;
        PG8_WAIT_V(2); PG8_BAR;
        PG8_STAGE(PG8_SB(1, 0), cB + kstep, voffB); PG8_STAGE(PG8_SA(1, 0), cA + kstep, voffA); PG8_STAGE(PG8_SB(1, 1), cB + hstep + kstep, voffB);
        PG8_WAIT_V(6); PG8_BAR;
    } else {
        PG8_STAGE(PG8_SB(0, 0), cB, voffB); PG8_STAGE(PG8_SA(0, 0), cA, voffA); PG8_STAGE(PG8_SB(0, 1), cB + hstep, voffB); PG8_STAGE(PG8_SA(0, 1), cA + hstep, voffA);
        if (wr == 1) PG8_BAR;
        PG8_WAIT_V(4); PG8_BAR;
        PG8_STAGE(PG8_SB(1, 0), cB + kstep, voffB); PG8_STAGE(PG8_SA(1, 0), cA + kstep, voffA); PG8_STAGE(PG8_SB(1, 1), cB + hstep + kstep, voffB);
        PG8_WAIT_V(6); PG8_BAR;
    }
    for (;;) {
        const bool has_next = S.next(ui + 1, nxt);
        const char* nA = has_next ? (const char*)g.A + (size_t)nxt.pm * tstep : cA; const char* nB = has_next ? (const char*)g.Bt + (size_t)nxt.pn * tstep : cB;
        for (int t = 0; t < nt; t += 2) {
            const bool last = (t == nt - 2);
            const char* a1 = cA + (size_t)(t + 1) * kstep;
            const char* a2 = last ? nA : cA + (size_t)(t + 2) * kstep; const char* b2 = last ? nB : cB + (size_t)(t + 2) * kstep;
            const char* a3 = a2 + kstep; const char* b3 = b2 + kstep;
            if (last && has_next) S.a_ready(nxt);
            if constexpr (SP2) {
            PG8_LDB(B0, 0, 0); PG8_LDB(B1, 0, 1); PG8_SCHED; PG8_LDA(At, 0, 0); PG8_STAGE(PG8_SA(1, 1), a1 + hstep, voffA);
            PG8_WAIT_V(8); PG8_WAIT_L(0); PG8_BAR; PG8_MMA(0, 0, At, B0); PG8_MMA(0, 1, At, B1); PG8_BAR; PG8_SCHED;
            PG8_LDA(At, 0, 1); PG8_STAGE(PG8_SB(0, 0), b2, voffB); PG8_STAGE(PG8_SB(0, 1), b2 + hstep, voffB); PG8_STAGE(PG8_SA(0, 0), a2, voffA);
            PG8_WAIT_V(8); PG8_WAIT_L(0); PG8_BAR; PG8_MMA(1, 0, At, B0); PG8_MMA(1, 1, At, B1); PG8_BAR; PG8_SCHED;
            PG8_LDB(B0, 1, 0); PG8_LDB(B1, 1, 1); PG8_SCHED; PG8_LDA(At, 1, 0); PG8_STAGE(PG8_SA(0, 1), a2 + hstep, voffA);
            PG8_WAIT_V(8); PG8_WAIT_L(0); PG8_BAR; PG8_MMA(0, 0, At, B0); PG8_MMA(0, 1, At, B1); PG8_BAR; PG8_SCHED;
            PG8_LDA(At, 1, 1); PG8_STAGE(PG8_SB(1, 0), b3, voffB); PG8_STAGE(PG8_SB(1, 1), b3 + hstep, voffB); PG8_STAGE(PG8_SA(1, 0), a3, voffA);
            PG8_WAIT_V(8); PG8_WAIT_L(0); PG8_BAR; PG8_MMA(1, 0, At, B0); PG8_MMA(1, 1, At, B1); PG8_BAR; PG8_SCHED;
            } else {
            PG8_LDB(B0, 0, 0); PG8_SCHED; PG8_LDA(At, 0, 0); PG8_STAGE(PG8_SA(1, 1), a1 + hstep, voffA);
            PG8_WAIT_L(8); PG8_BAR; PG8_WAIT_L(0); PG8_MMA(0, 0, At, B0); PG8_BAR; PG8_SCHED;
            PG8_LDB(B1, 0, 1); PG8_STAGE(PG8_SB(0, 0), b2, voffB);
            PG8_BAR; PG8_WAIT_L(0); PG8_MMA(0, 1, At, B1); PG8_BAR;
            PG8_LDA(At, 0, 1); PG8_STAGE(PG8_SA(0, 0), a2, voffA);
            PG8_BAR; PG8_WAIT_L(0); PG8_MMA(1, 0, At, B0); PG8_BAR; PG8_SCHED;
            PG8_STAGE(PG8_SB(0, 1), b2 + hstep, voffB);
            PG8_WAIT_V(6); PG8_BAR; PG8_MMA(1, 1, At, B1); PG8_BAR;
            PG8_LDB(B0, 1, 0); PG8_SCHED; PG8_LDA(At, 1, 0); PG8_STAGE(PG8_SA(0, 1), a2 + hstep, voffA);
            PG8_WAIT_L(8); PG8_BAR; PG8_WAIT_L(0); PG8_MMA(0, 0, At, B0); PG8_BAR; PG8_SCHED;
            PG8_LDB(B1, 1, 1); PG8_STAGE(PG8_SB(1, 0), b3, voffB);
            PG8_BAR; PG8_WAIT_L(0); PG8_MMA(0, 1, At, B1); PG8_BAR;
            PG8_LDA(At, 1, 1); PG8_STAGE(PG8_SA(1, 0), a3, voffA);
            PG8_BAR; PG8_WAIT_L(0); PG8_MMA(1, 0, At, B0); PG8_BAR; PG8_SCHED;
            PG8_STAGE(PG8_SB(1, 1), b3 + hstep, voffB);
            PG8_WAIT_V(6); PG8_BAR; PG8_MMA(1, 1, At, B1); PG8_BAR;
            }
        }
        if constexpr (ALIGN_EPI) { if (wr == 0) PG8_BAR; }
        if constexpr (!Epi::AFTER_DRAIN) { E(acc, cur, wr, wc, fr, fq); S.done(cur); }
        if (!has_next) break;
#pragma unroll
        for (int a = 0; a < 2; ++a)
#pragma unroll
            for (int b = 0; b < 2; ++b)
#pragma unroll
                for (int m = 0; m < 4; ++m)
#pragma unroll
                    for (int n = 0; n < 2; ++n) acc[a][b][m][n] = (f32x4){0.f, 0.f, 0.f, 0.f};
        cur = nxt; cA = nA; cB = nB; ++ui;
        if constexpr (ALIGN_EPI) { if (wr == 1) PG8_BAR; }
    }
    PG8_WAIT_V(0);
    if constexpr (!ALIGN_EPI) { if (wr == 0) PG8_BAR; }
    PG8_BAR;
    if constexpr (Epi::AFTER_DRAIN) { E.fused(acc, cur, wr, wc, fr, fq, lds, wid, lane); S.done(cur); }
#undef PG8_SA
#undef PG8_SB
#undef PG8_STAGE
#undef PG8_LDA
#undef PG8_LDB
#undef PG8_MMA
#undef PG8_WAIT_V
#undef PG8_WAIT_L
#undef PG8_BAR
#undef PG8_SCHED
}
}
#define GAS __attribute__((address_space(1)))
#define LAS __attribute__((address_space(3)))
typedef unsigned short bf16;
typedef unsigned v4u __attribute__((ext_vector_type(4)));
typedef float f32x4 __attribute__((ext_vector_type(4)));
typedef short bf16x8 __attribute__((ext_vector_type(8)));
typedef GAS unsigned gu32;
typedef GAS unsigned long long gu64;
#define RLX_AGENT __ATOMIC_RELAXED, __HIP_MEMORY_SCOPE_AGENT
#define LDS_WAIT() asm volatile("s_waitcnt lgkmcnt(0)" ::: "memory")
#define VM_WAIT() asm volatile("s_waitcnt vmcnt(0)" ::: "memory")
__device__ __forceinline__ unsigned long long rt() { return __builtin_amdgcn_s_memrealtime(); }
__device__ __forceinline__ unsigned f2bf(float f) { unsigned u = __builtin_bit_cast(unsigned, f); return (u + 0x7fffu + ((u >> 16) & 1u)) >> 16; }
__device__ __forceinline__ unsigned pk2(float lo, float hi) { return f2bf(lo) | (f2bf(hi) << 16); }

#define XB_TMO      128
#define XB_XCNT(j)  (256  + 64 * (j))
#define XB_XSUB(j)  (1280 + 64 * (j))
#define XB_XGEN(j)  (2304 + 64 * (j))
#define XB_TOP      3328
#define XB_TOPGEN   3392
#define XCD_BAR_WORDS 3456
#define XB_SPIN_CAP (1u << 18)

__device__ __forceinline__ unsigned xb_ld(unsigned* p)              { return __hip_atomic_load(p, __ATOMIC_RELAXED, __HIP_MEMORY_SCOPE_AGENT); }
__device__ __forceinline__ unsigned xb_add(unsigned* p, unsigned v) { return __hip_atomic_fetch_add(p, v, __ATOMIC_RELAXED, __HIP_MEMORY_SCOPE_AGENT); }
__device__ __forceinline__ unsigned xb_xcc_id() { return (unsigned)__builtin_amdgcn_s_getreg((3 << 11) | 20) & 0xFu; }
#define XB_SPIN(cond, bar) do { unsigned _sp = 0; while (cond) { __builtin_amdgcn_s_sleep(1); \
    if ((++_sp & 255u) == 0u) { if (xb_ld(&(bar)[XB_TMO])) break; if (_sp > XB_SPIN_CAP) { atomicAdd(&(bar)[XB_TMO], 1u); break; } } } } while (0)

struct XcdBarrier {
    unsigned* bar; unsigned x;
    volatile LAS unsigned* st;
};

__device__ __forceinline__ XcdBarrier xcd_barrier_post(unsigned* bar, volatile LAS unsigned* st) {
    XcdBarrier b; b.bar = bar; b.x = xb_xcc_id(); b.st = st;
    if (threadIdx.x == 0) (void)xb_add(&bar[XB_XCNT(b.x)], 1u);
    return b;
}
__device__ __forceinline__ void xcd_barrier_complete(unsigned* bar, unsigned x, unsigned& nloc, unsigned& nx) {
    const unsigned G = gridDim.x * gridDim.y * gridDim.z;
    unsigned sum, cnt, mine, sp = 0u;
    for (;;) {
        sum = 0u; cnt = 0u; mine = 0u;
#pragma unroll
        for (unsigned j = 0; j < 16; ++j) { const unsigned c = xb_ld(&bar[XB_XCNT(j)]); sum += c; cnt += (c > 0u) ? 1u : 0u; mine = (j == x) ? c : mine; }
        if (sum == G) break;
        __builtin_amdgcn_s_sleep(1);
        if ((++sp & 255u) == 0u) { if (xb_ld(&bar[XB_TMO])) break; if (sp > XB_SPIN_CAP) { atomicAdd(&bar[XB_TMO], 1u); break; } }
    }
    nloc = mine > 0u ? mine : 1u; nx = cnt > 0u ? cnt : 1u;
}

__device__ __forceinline__ void xcd_barrier(const XcdBarrier& b) {
    asm volatile("s_waitcnt vmcnt(0)" ::: "memory");
    __syncthreads();
    if (threadIdx.x == 0) {
        unsigned* bar = b.bar;
        __builtin_amdgcn_s_waitcnt(0);
        unsigned nloc = b.st[0], nx = b.st[1];
        if (nloc == 0u) { xcd_barrier_complete(bar, b.x, nloc, nx); b.st[0] = nloc; b.st[1] = nx; }
        const unsigned old = xb_add(&bar[XB_XSUB(b.x)], 1u);
        const unsigned gen = old / nloc;
        if (old + 1u == (gen + 1u) * nloc) {
            __builtin_amdgcn_fence(__ATOMIC_RELEASE, "agent");
            asm volatile("s_waitcnt vmcnt(0)" ::: "memory");
            const unsigned og = xb_add(&bar[XB_TOP], 1u);
            const unsigned tg = og / nx;
            if (og + 1u == (tg + 1u) * nx) xb_add(&bar[XB_TOPGEN], 1u);
            else XB_SPIN(xb_ld(&bar[XB_TOPGEN]) == tg, bar);
            __builtin_amdgcn_fence(__ATOMIC_ACQUIRE, "agent");
            xb_add(&bar[XB_XGEN(b.x)], 1u);
            asm volatile("s_waitcnt vmcnt(0)" ::: "memory");
        } else {
            XB_SPIN(xb_ld(&bar[XB_XGEN(b.x)]) == gen, bar);
            __builtin_amdgcn_fence(__ATOMIC_ACQUIRE, "agent");
            asm volatile("s_waitcnt vmcnt(0)" ::: "memory");
        }
    }
    __syncthreads();
}


constexpr int NWAVES = 8;
constexpr int M = 16896, NPROMPT = 16384, SEQ = 8192, DEC_SEQ = 32, DEC_B = 16;
constexpr int D = 1024, FF = 2816, DC = 512, DP = 512, NGU = 2 * FF, NIG = 3584, NGATE = 2048;
constexpr float ALPHA = 1.1892071150027210667f;
constexpr float LN_EPS = 1e-5f;
constexpr size_t OUT_Y = 0, OUT_NCP = (size_t)M * D, OUT_NCS = OUT_NCP + 2 * 30 * 512, OUT_NPP = OUT_NCS + 16 * 30 * 512, OUT_NPS = OUT_NPP + 2 * 15 * 512;
constexpr size_t MiB = 1u << 20, HMiB = 1u << 19;
constexpr size_t WS_CTL = 0, CTL_ZERO_BYTES = 1 * MiB;
constexpr size_t WS_WGU1 = 1 * MiB, WS_WD1 = 12 * MiB, WS_WIG = 35 * HMiB, WS_WCP = 49 * HMiB, WS_WPP = 51 * HMiB, WS_WPG = 53 * HMiB, WS_WOUT = 27 * MiB, WS_WGU2 = 29 * MiB, WS_WD2 = 40 * MiB;
constexpr size_t WS_H1 = 46 * MiB;
constexpr size_t WS_GLU = 46 * MiB, WS_PIN = 79 * MiB, WS_AC = 112 * MiB, WS_MXB = 46 * MiB;
constexpr size_t WS_T = 137 * MiB, WS_GATES = 137 * MiB;
constexpr size_t WS_XB = 203 * MiB, WS_AP0 = 203 * MiB, WS_AP = 439 * HMiB;
constexpr size_t WS_END = 236 * MiB;
constexpr int CW_BAR = 4096;
constexpr int RING_OFF = 0, RING_BYTES = 131072;
constexpr int LDSCTL_OFF = RING_BYTES, MISC_OFF = LDSCTL_OFF + 320;
constexpr int LDS_BYTES = 147456;
static_assert(MISC_OFF + 128 <= LDS_BYTES, "LDS map");

__device__ __forceinline__ float wave_sum(float v) {
#pragma unroll
    for (int o = 1; o < 64; o <<= 1) v += __shfl_xor(v, o);
    return v;
}

__device__ __forceinline__ void p0_transpose_item(const float* W, int ldw, int K, bf16* WT, int k0, int n0, int drow0, LAS float* scr, int lane) {
#pragma unroll 8
    for (int i = 0; i < 32; ++i) { const int kk = 2 * i + (lane >> 5); scr[kk * 33 + (lane & 31)] = W[(size_t)(k0 + kk) * ldw + n0 + (lane & 31)]; }
    LDS_WAIT(); asm volatile("" ::: "memory");
    const int c = lane & 7;
#pragma unroll
    for (int j = 0; j < 4; ++j) { const int n = (lane >> 3) + 8 * j; const LAS float* s = scr + (8 * c) * 33 + n;
        v4u o; o.x = pk2(s[0 * 33], s[1 * 33]); o.y = pk2(s[2 * 33], s[3 * 33]); o.z = pk2(s[4 * 33], s[5 * 33]); o.w = pk2(s[6 * 33], s[7 * 33]);
        *(GAS v4u*)(WT + (size_t)(drow0 + n) * K + k0 + 8 * c) = o; }
    LDS_WAIT(); asm volatile("" ::: "memory");
}
__device__ __forceinline__ int rowmap(int mode, int n) { return mode == 0 ? n : (256 * (n >> 7) + (n & 127) + (mode == 2 ? 128 : 0)); }

struct Args { const float* in[28]; float* out; unsigned char* ws; };
template <int OFF> __device__ __forceinline__ unsigned long long karg_u64() {
    unsigned long long v; auto ka = __builtin_amdgcn_kernarg_segment_ptr();
    asm volatile("s_load_dwordx2 %0, %1, %2\n\ts_waitcnt lgkmcnt(0)" : "=s"(v) : "s"(ka), "i"(OFF) : "memory");
    return v;
}
#define ARG_IN(i) ((const float*)(const GAS float*)karg_u64<8 * (i)>())
#define ARG_OUT() ((float*)(GAS float*)karg_u64<8 * 28>())
#define ARG_WS() ((unsigned char*)(GAS unsigned char*)karg_u64<8 * 29>())

__device__ __forceinline__ void p0_prologue(LAS unsigned char* lds, int gw, int NGW, int wave, int lane, int gtid, int NGT) {
    LAS float* scr = (LAS float*)(lds + RING_OFF + wave * 16384);
    unsigned char* ws = ARG_WS();
    constexpr int NJ = 13;
    int start = 0;
#pragma unroll 1
    for (int j = 0; j < NJ; ++j) {
        const float* W; int ldw, ncols, K, mode, rowoff; bf16* WT;
        switch (j) {
            case 0:  W = ARG_IN(4);         ldw = FF;   ncols = FF;   K = D;  WT = (bf16*)(ws + WS_WGU1); mode = 1; rowoff = 0; break;
            case 1:  W = ARG_IN(5);         ldw = FF;   ncols = FF;   K = D;  WT = (bf16*)(ws + WS_WGU1); mode = 2; rowoff = 0; break;
            case 2:  W = ARG_IN(6);         ldw = D;    ncols = D;    K = FF; WT = (bf16*)(ws + WS_WD1);  mode = 0; rowoff = 0; break;
            case 3:  W = ARG_IN(9);         ldw = 1536; ncols = 512;  K = D;  WT = (bf16*)(ws + WS_WIG);  mode = 1; rowoff = 0; break;
            case 4:  W = ARG_IN(9) + 512;   ldw = 1536; ncols = 512;  K = D;  WT = (bf16*)(ws + WS_WIG);  mode = 2; rowoff = 0; break;
            case 5:  W = ARG_IN(9) + 1024;  ldw = 1536; ncols = 512;  K = D;  WT = (bf16*)(ws + WS_WIG);  mode = 0; rowoff = 1024; break;
            case 6:  W = ARG_IN(10);        ldw = 2048; ncols = 2048; K = D;  WT = (bf16*)(ws + WS_WIG);  mode = 0; rowoff = 1536; break;
            case 7:  W = ARG_IN(16);        ldw = D;    ncols = D;    K = DC; WT = (bf16*)(ws + WS_WCP);  mode = 0; rowoff = 0; break;
            case 8:  W = ARG_IN(19);        ldw = D;    ncols = D;    K = DP; WT = (bf16*)(ws + WS_WPP);  mode = 0; rowoff = 0; break;
            case 9:  W = ARG_IN(20);        ldw = D;    ncols = D;    K = D;  WT = (bf16*)(ws + WS_WOUT); mode = 0; rowoff = 0; break;
            case 10: W = ARG_IN(23);        ldw = FF;   ncols = FF;   K = D;  WT = (bf16*)(ws + WS_WGU2); mode = 1; rowoff = 0; break;
            case 11: W = ARG_IN(24);        ldw = FF;   ncols = FF;   K = D;  WT = (bf16*)(ws + WS_WGU2); mode = 2; rowoff = 0; break;
            default: W = ARG_IN(25);        ldw = D;    ncols = D;    K = FF; WT = (bf16*)(ws + WS_WD2);  mode = 0; rowoff = 0; break;
        }
        const int nblk = ncols / 32, nitems = (K / 64) * nblk;
        int first = gw - (start % NGW); if (first < 0) first += NGW;
        for (int it = first; it < nitems; it += NGW) { const int kb = it / nblk, nb = it % nblk; p0_transpose_item(W, ldw, K, WT, 64 * kb, 32 * nb, rowoff + rowmap(mode, 32 * nb), scr, lane); }
        start += nitems;
    }
    { const float* wpg = ARG_IN(17); const float* psc = ARG_IN(18); bf16* WPG = (bf16*)(ws + WS_WPG);
      for (int c = gtid; c < 512 * 64; c += NGT) { const int n = c >> 6, k0 = (c & 63) * 8, g = n >> 7; v4u o = (v4u){0u, 0u, 0u, 0u};
          if ((k0 >> 7) == g) { const float sc = psc[n]; const float* s = wpg + ((size_t)(g * 128 + (k0 & 127)) * 128 + (n & 127));
              o.x = pk2(s[0] * sc, s[128] * sc); o.y = pk2(s[256] * sc, s[384] * sc); o.z = pk2(s[512] * sc, s[640] * sc); o.w = pk2(s[768] * sc, s[896] * sc); }
          *(GAS v4u*)(WPG + (size_t)n * 512 + k0) = o; } }
    { bf16* XB = (bf16*)(ws + WS_XB);
      for (int m = gw; m < M; m += NGW) { const float* xrow = (m < NPROMPT) ? ARG_IN(0) + (size_t)m * D : ARG_IN(1) + (size_t)(m - NPROMPT) * D;
          const GAS f32x4* xr = (const GAS f32x4*)xrow + lane; GAS unsigned long long* o8 = (GAS unsigned long long*)(XB + (size_t)m * D) + lane;
#pragma unroll
          for (int j = 0; j < 4; ++j) { const f32x4 v = xr[64 * j]; o8[64 * j] = (unsigned long long)pk2(v.x, v.y) | ((unsigned long long)pk2(v.z, v.w) << 32); } } }
}

template <int MODE>
__device__ __forceinline__ void ln_phase(const float* xp, const float* xs, const float* resf, const float* T, float tscale, const float* gamma, const float* beta,
                                         float* outf, bf16* outb, int gw, int NGW, int lane) {
    f32x4 gm[4], bt[4];
#pragma unroll
    for (int j = 0; j < 4; ++j) { gm[j] = ((const f32x4*)gamma)[64 * j + lane]; bt[j] = ((const f32x4*)beta)[64 * j + lane]; }
    for (int m = gw; m < M; m += NGW) {
        const float* rrow = (MODE == 1) ? ((m < NPROMPT) ? xp + (size_t)m * D : xs + (size_t)(m - NPROMPT) * D) : resf + (size_t)m * D;
        const GAS f32x4* rr = (const GAS f32x4*)rrow + lane; const GAS f32x4* tr = (const GAS f32x4*)(T + (size_t)m * D) + lane;
        f32x4 v[4]; float s = 0.f;
#pragma unroll
        for (int j = 0; j < 4; ++j) { const f32x4 r = rr[64 * j], t = tr[64 * j]; v[j] = r * ALPHA + t * tscale; s += (v[j].x + v[j].y) + (v[j].z + v[j].w); }
        const float mean = wave_sum(s) * (1.f / D); float s2 = 0.f;
#pragma unroll
        for (int j = 0; j < 4; ++j) { v[j] = v[j] - mean; s2 += (v[j].x * v[j].x + v[j].y * v[j].y) + (v[j].z * v[j].z + v[j].w * v[j].w); }
        const float rstd = 1.f / sqrtf(wave_sum(s2) * (1.f / D) + LN_EPS);
#pragma unroll
        for (int j = 0; j < 4; ++j) { const f32x4 o = v[j] * rstd * gm[j] + bt[j];
            if (outf) ((GAS f32x4*)(outf + (size_t)m * D))[64 * j + lane] = o;
            if (outb) ((GAS unsigned long long*)(outb + (size_t)m * D))[64 * j + lane] = (unsigned long long)pk2(o.x, o.y) | ((unsigned long long)pk2(o.z, o.w) << 32); }
    }
}

typedef float f32x2m __attribute__((ext_vector_type(2)));
template <int RPW>
__device__ __forceinline__ void mixer_tile(int r0, bool prompt, int seq, int t0, LAS unsigned char* lds, int wave, int lane, int tid) {
    constexpr int NR = 8 * RPW, EXC = NR + 30, EXP = NR + 15;
    unsigned char* ws = ARG_WS();
    const float* glu = (const float*)(ws + WS_GLU); const float* pin = (const float*)(ws + WS_PIN);
    bf16* AC = (bf16*)(ws + WS_AC); bf16* AP0 = (bf16*)(ws + WS_AP0);
    const float* stc = ARG_IN(2); const float* stp = ARG_IN(3);
    const float* cw = ARG_IN(12); const float* cb = ARG_IN(13); const float* clg = ARG_IN(14); const float* clb = ARG_IN(15);
    const int s0 = r0 - t0;
    const int L = prompt ? SEQ : DEC_SEQ;
    float* ncv = ARG_OUT() + (prompt ? OUT_NCP : OUT_NCS) + (size_t)seq * 30 * 512;
    float* npl = ARG_OUT() + (prompt ? OUT_NPP : OUT_NPS) + (size_t)seq * 15 * 512;
    LAS float* ext = (LAS float*)lds;
    LAS float* wl = (LAS float*)(lds + 49152);
    f32x2m dc[4][RPW];
#pragma unroll
    for (int q = 0; q < 4; ++q) {
        __syncthreads();
        for (int idx = tid; idx < (EXC + 1) * 32; idx += NWAVES * 64) {
            const int jj = idx >> 5, c = 128 * q + (idx & 31) * 4, tau = t0 - 30 + jj;
            const float* src = (tau >= 0) ? glu + (size_t)(s0 + tau) * 512 : (prompt ? glu + (size_t)s0 * 512 : stc + (size_t)(seq * 30 + 30 + tau) * 512);
            const float msk = (tau >= 0 || !prompt) ? 1.f : 0.f;
            f32x4 e = (f32x4){0.f, 0.f, 0.f, 0.f};
            if (jj < EXC) e = *(const f32x4*)(src + c) * msk;
            *(LAS f32x4*)(ext + jj * 128 + (idx & 31) * 4) = e;
            if (jj >= 30 && jj < EXC && tau >= L - 30) *(f32x4*)(ncv + (size_t)(tau - (L - 30)) * 512 + c) = e;
        }
        for (int idx = tid; idx < 32 * 32; idx += NWAVES * 64) {
            const int k = idx >> 5; f32x4 e = (f32x4){0.f, 0.f, 0.f, 0.f};
            if (k < 31) e = *(const f32x4*)(cw + k * 512 + 128 * q + (idx & 31) * 4);
            *(LAS f32x4*)(wl + k * 128 + (idx & 31) * 4) = e;
        }
        __syncthreads();
        const int c2 = 128 * q + 2 * lane;
        const f32x2m bias = *(const f32x2m*)(cb + c2);
        f32x2m acc[RPW];
#pragma unroll
        for (int o = 0; o < RPW; ++o) acc[o] = bias;
        const LAS float* er = ext + (wave * RPW) * 128 + 2 * lane;
        const LAS float* wr_ = wl + 2 * lane;
#pragma unroll 1
        for (int kb = 0; kb < 4; ++kb) {
            f32x2m e[RPW + 7], wv[8];
#pragma unroll
            for (int i = 0; i < RPW + 7; ++i) e[i] = *(const LAS f32x2m*)(er + (8 * kb + i) * 128);
#pragma unroll
            for (int j = 0; j < 8; ++j) wv[j] = *(const LAS f32x2m*)(wr_ + (8 * kb + j) * 128);
#pragma unroll
            for (int o = 0; o < RPW; ++o)
#pragma unroll
                for (int j = 0; j < 8; ++j) acc[o] += wv[j] * e[o + j];
        }
#pragma unroll
        for (int o = 0; o < RPW; ++o) dc[q][o] = acc[o];
    }
    {
        f32x2m g[4], b[4];
#pragma unroll
        for (int q = 0; q < 4; ++q) { g[q] = *(const f32x2m*)(clg + 128 * q + 2 * lane); b[q] = *(const f32x2m*)(clb + 128 * q + 2 * lane); }
#pragma unroll
        for (int o = 0; o < RPW; ++o) {
            float s = 0.f;
#pragma unroll
            for (int q = 0; q < 4; ++q) s += dc[q][o].x + dc[q][o].y;
            const float mean = wave_sum(s) * (1.f / 512.f);
            float qq = 0.f;
#pragma unroll
            for (int q = 0; q < 4; ++q) { dc[q][o] = dc[q][o] - mean; qq += dc[q][o].x * dc[q][o].x + dc[q][o].y * dc[q][o].y; }
            const float rstd = 1.f / sqrtf(wave_sum(qq) * (1.f / 512.f) + LN_EPS);
            bf16* orow = AC + (size_t)(r0 + wave * RPW + o) * 512 + 2 * lane;
#pragma unroll
            for (int q = 0; q < 4; ++q) { const f32x2m y = dc[q][o] * rstd * g[q] + b[q];
                *(GAS unsigned*)(orow + 128 * q) = pk2(y.x * pg8::fsigmoid(y.x), y.y * pg8::fsigmoid(y.y)); }
        }
    }
#pragma unroll
    for (int q = 0; q < 4; ++q) {
        constexpr int dummy = 0; (void)dummy;
        const int wlen = 2 << q;
        __syncthreads();
        for (int idx = tid; idx < EXP * 32; idx += NWAVES * 64) {
            const int jj = idx >> 5, c = 128 * q + (idx & 31) * 4, tau = t0 - 15 + jj;
            const float* src = (tau >= 0) ? pin + (size_t)(s0 + tau) * 512 : (prompt ? pin + (size_t)s0 * 512 : stp + (size_t)(seq * 15 + 15 + tau) * 512);
            const float msk = (tau >= 0 || !prompt) ? 1.f : 0.f;
            const f32x4 e = *(const f32x4*)(src + c) * msk;
            *(LAS f32x4*)(ext + jj * 128 + (idx & 31) * 4) = e;
            if (jj >= 15 && tau >= L - 15) *(f32x4*)(npl + (size_t)(tau - (L - 15)) * 512 + c) = e;
        }
        __syncthreads();
        f32x2m sum[RPW], self[RPW];
#pragma unroll
        for (int o = 0; o < RPW; ++o) { sum[o] = (f32x2m){0.f, 0.f}; self[o] = (f32x2m){0.f, 0.f}; }
        const LAS float* er = ext + (wave * RPW) * 128 + 2 * lane;
#pragma unroll
        for (int jj = 0; jj < RPW + 15; ++jj) {
            const f32x2m e = *(const LAS f32x2m*)(er + jj * 128);
#pragma unroll
            for (int o = 0; o < RPW; ++o) { const int d = 15 + o - jj; if (d >= 0 && d < wlen) sum[o] += e; if (d == 0) self[o] = e; }
        }
#pragma unroll
        for (int o = 0; o < RPW; ++o) {
            const int pos1 = t0 + wave * RPW + o + 1;
            const int cnt = prompt ? (pos1 < wlen ? pos1 : wlen) : wlen;
            const f32x2m p = sum[o] * (1.f / (float)cnt) - self[o];
            *(GAS unsigned*)(AP0 + (size_t)(r0 + wave * RPW + o) * 512 + 128 * q + 2 * lane) = pk2(p.x, p.y);
        }
    }
    __syncthreads();
}
__device__ __forceinline__ void mixer_phase(LAS unsigned char* lds, int vcu, int G, int wave, int lane, int tid) {
    for (int t = vcu; t < 256 + 16; t += G) {
        if (t < 256) { const int r0 = t * 64; mixer_tile<8>(r0, true, r0 >> 13, r0 & (SEQ - 1), lds, wave, lane, tid); }
        else { const int s = t - 256; mixer_tile<4>(NPROMPT + s * 32, false, s, 0, lds, wave, lane, tid); }
    }
}


#ifndef DBG_STOP
#define DBG_STOP -1
#endif
__device__ __forceinline__ float bf2f(bf16 b) { return __uint_as_float(((unsigned)b) << 16); }
template <int KIND> __device__ __forceinline__ void dbg_dump(const void* pa, const void* pb, float* out, int gtid, int NGT) {
    for (size_t i = gtid; i < (size_t)M * D; i += NGT) { const int m = (int)(i >> 10), c = (int)(i & 1023); float v = 0.f;
        if (KIND == 1) v = bf2f(((const bf16*)pa)[i]);
        if (KIND == 2) v = c < 512 ? bf2f(((const bf16*)pa)[(size_t)m * 512 + c]) : bf2f(((const bf16*)pb)[(size_t)m * 512 + c - 512]);
        if (KIND == 3) v = ((const float*)pa)[i];
        if (KIND == 4) v = c < 512 ? ((const float*)pa)[(size_t)m * 512 + c] : ((const float*)pb)[(size_t)m * 512 + c - 512];
        if (KIND == 5) { const bf16* h = (const bf16*)pa + (size_t)m * FF; v = bf2f(h[c]) + bf2f(h[c + 1024]) + (c < 768 ? bf2f(h[c + 2048]) : 0.f); }
        if (KIND == 6) { const unsigned* g = (const unsigned*)((const bf16*)pa + (size_t)m * 2048); const unsigned w0 = __hip_atomic_load(g + (c >> 1), __ATOMIC_RELAXED, __HIP_MEMORY_SCOPE_AGENT), w1 = __hip_atomic_load(g + 512 + (c >> 1), __ATOMIC_RELAXED, __HIP_MEMORY_SCOPE_AGENT);
            v = (c & 1) ? __uint_as_float(w0 & 0xffff0000u) + __uint_as_float(w1 & 0xffff0000u) : __uint_as_float(w0 << 16) + __uint_as_float(w1 << 16); }
        if (KIND == 8) v = ((const float*)pa)[(c + 1024 * (m & 1))];
        if (KIND == 7) v = bf2f(((const bf16*)pa)[(size_t)(1536 + (m & 2047)) * 1024 + c]);
        out[i] = v; }
}
#define DBG_AT(k, KIND, pa, pb) do { if (DBG_STOP == (k)) { dbg_dump<KIND>(pa, pb, ARG_OUT(), gtid, NGT); return; } } while (0)

__device__ __forceinline__ void dbg_scrub(int vcu, int tid) {
    const f32x4* p = (const f32x4*)ARG_IN(0) + (size_t)(vcu & 31) * 131072;
    f32x4 s = (f32x4){0.f, 0.f, 0.f, 0.f};
    for (int i = tid; i < 131072; i += NWAVES * 64) s += p[i];
    asm volatile("" :: "v"(s));
}
__global__ void __launch_bounds__(NWAVES * 64, 2) fwd_kernel(Args args) {
    extern __shared__ __attribute__((aligned(16))) unsigned char lds_raw[];
    LAS unsigned char* lds = (LAS unsigned char*)lds_raw;
    volatile LAS unsigned* MISC = (volatile LAS unsigned*)(lds + MISC_OFF);
    const int tid = threadIdx.x, lane = tid & 63, wave = __builtin_amdgcn_readfirstlane(tid >> 6);
    const int G = gridDim.x; const int bx = blockIdx.x; const int vcu = (G % 8 == 0) ? (bx % 8) * (G / 8) + bx / 8 : bx;
    const int gw = vcu * NWAVES + wave, NGW = G * NWAVES, gtid = vcu * (NWAVES * 64) + tid, NGT = G * NWAVES * 64;
    unsigned char* ws = ARG_WS();
    gu32* ctl = (gu32*)(ws + WS_CTL);
    for (int u = tid; u < (LDS_BYTES - LDSCTL_OFF) / 4; u += NWAVES * 64) ((LAS unsigned*)(lds + LDSCTL_OFF))[u] = 0u;
    __syncthreads();
    XcdBarrier bar = xcd_barrier_post((unsigned*)(ctl + CW_BAR), MISC + 8);

    bf16* WGU1 = (bf16*)(ws + WS_WGU1); bf16* WD1 = (bf16*)(ws + WS_WD1); bf16* WIG = (bf16*)(ws + WS_WIG); bf16* WCP = (bf16*)(ws + WS_WCP); bf16* WPP = (bf16*)(ws + WS_WPP);
    bf16* WPG = (bf16*)(ws + WS_WPG); bf16* WOUT = (bf16*)(ws + WS_WOUT); bf16* WGU2 = (bf16*)(ws + WS_WGU2); bf16* WD2 = (bf16*)(ws + WS_WD2);
    bf16* H1 = (bf16*)(ws + WS_H1); float* GLU = (float*)(ws + WS_GLU); float* PIN = (float*)(ws + WS_PIN); bf16* AC = (bf16*)(ws + WS_AC); bf16* MXB = (bf16*)(ws + WS_MXB);
    float* T = (float*)(ws + WS_T); bf16* GATES = (bf16*)(ws + WS_GATES); bf16* XB = (bf16*)(ws + WS_XB); bf16* AP0 = (bf16*)(ws + WS_AP0); bf16* AP = (bf16*)(ws + WS_AP);
    float* HF = ARG_OUT() + OUT_Y;
    LAS unsigned char* ring = lds + RING_OFF;

    p0_prologue(lds, gw, NGW, wave, lane, gtid, NGT);
    xcd_barrier(bar);
    DBG_AT(0, 1, XB, XB); DBG_AT(41, 7, WIG, WIG);
    { pg8::Gemm g{XB, WGU1, M, NGU, D}; pg8::StaticOrder S; S.init(M, NGU, G, bx); pg8::EpiGU E{H1, FF};
      pg8::gemm_phase<pg8::EpiGU, pg8::StaticOrder, true, true>(ring, g, S, E); }
    xcd_barrier(bar);
    DBG_AT(1, 5, H1, H1);
    { pg8::Gemm g{H1, WD1, M, D, FF}; pg8::StaticOrder S; S.init(M, D, G, bx); pg8::EpiF32 E{T, D};
      pg8::gemm_phase<pg8::EpiF32, pg8::StaticOrder, true, true>(ring, g, S, E); }
    xcd_barrier(bar);
    DBG_AT(2, 3, T, T);
    ln_phase<1>(ARG_IN(0), ARG_IN(1), nullptr, T, 0.5f, ARG_IN(7), ARG_IN(8), HF, XB, gw, NGW, lane);
    xcd_barrier(bar);
    DBG_AT(3, 1, XB, XB);
#ifdef DBG_SCRUB
    dbg_scrub(vcu, tid); xcd_barrier(bar);
#endif
    { pg8::Gemm g{XB, WIG, M, NIG, D}; pg8::StaticOrder S; S.init(M, NIG, G, bx); pg8::EpiIG E{GLU, PIN, GATES, ARG_IN(11)};
      pg8::gemm_phase<pg8::EpiIG, pg8::StaticOrder, true, true>(ring, g, S, E); }
    xcd_barrier(bar);
    DBG_AT(4, 4, GLU, PIN); DBG_AT(40, 6, GATES, GATES); DBG_AT(42, 8, ARG_IN(11), nullptr);
    mixer_phase(ring, vcu, G, wave, lane, tid);
    xcd_barrier(bar);
    DBG_AT(5, 2, AC, AP0);
    { pg8::Gemm g{AP0, WPG, M, DP, DP}; pg8::StaticOrder S; S.init(M, DP, G, bx); pg8::EpiB16 E{AP, DP};
      pg8::gemm_phase<pg8::EpiB16, pg8::StaticOrder, true, true>(ring, g, S, E); }
    xcd_barrier(bar);
    DBG_AT(6, 2, AP, AP);
    { pg8::Gemm g{AC, WCP, M, D, DC}; pg8::StaticOrder S; S.init(M, D, G, bx); pg8::EpiGate<0> E{MXB, GATES, 0};
      pg8::gemm_phase<pg8::EpiGate<0>, pg8::StaticOrder, true, true>(ring, g, S, E); }
    { pg8::Gemm g{AP, WPP, M, D, DP}; pg8::StaticOrder S; S.init(M, D, G, bx); pg8::EpiGate<1> E{MXB, GATES, 1024};
      pg8::gemm_phase<pg8::EpiGate<1>, pg8::StaticOrder, true, true>(ring, g, S, E); }
    xcd_barrier(bar);
    DBG_AT(8, 1, MXB, MXB);
    { pg8::Gemm g{MXB, WOUT, M, D, D}; pg8::StaticOrder S; S.init(M, D, G, bx); pg8::EpiF32 E{T, D};
      pg8::gemm_phase<pg8::EpiF32, pg8::StaticOrder, true, true>(ring, g, S, E); }
    xcd_barrier(bar);
    DBG_AT(9, 3, T, T);
    ln_phase<2>(nullptr, nullptr, HF, T, 1.0f, ARG_IN(21), ARG_IN(22), HF, XB, gw, NGW, lane);
    xcd_barrier(bar);
    DBG_AT(10, 1, XB, XB);
    { pg8::Gemm g{XB, WGU2, M, NGU, D}; pg8::StaticOrder S; S.init(M, NGU, G, bx); pg8::EpiGU E{H1, FF};
      pg8::gemm_phase<pg8::EpiGU, pg8::StaticOrder, true, true>(ring, g, S, E); }
    xcd_barrier(bar);
    { pg8::Gemm g{H1, WD2, M, D, FF}; pg8::StaticOrder S; S.init(M, D, G, bx); pg8::EpiF32 E{T, D};
      pg8::gemm_phase<pg8::EpiF32, pg8::StaticOrder, true, true>(ring, g, S, E); }
    xcd_barrier(bar);
    ln_phase<3>(nullptr, nullptr, HF, T, 0.5f, ARG_IN(26), ARG_IN(27), HF, nullptr, gw, NGW, lane);
}

extern "C" void kernel_launch(void* const* d_in, const int* in_sizes, int n_in, void* d_out, int out_size, void* d_ws, size_t ws_size, hipStream_t stream) {
    static int grid = 0;
    if (grid == 0) {
        if (n_in != 28 || ws_size < WS_END) { fprintf(stderr, "kernel_launch: unexpected n_in %d / ws %zu\n", n_in, ws_size); grid = -1; return; }
        int dev = 0, cus = 0, per_cu = 0;
        if (hipGetDevice(&dev) != hipSuccess || hipDeviceGetAttribute(&cus, hipDeviceAttributeMultiprocessorCount, dev) != hipSuccess) { grid = -1; return; }
        if (hipFuncSetAttribute((const void*)fwd_kernel, hipFuncAttributeMaxDynamicSharedMemorySize, LDS_BYTES) != hipSuccess) { fprintf(stderr, "kernel_launch: hipFuncSetAttribute failed\n"); grid = -1; return; }
        if (hipOccupancyMaxActiveBlocksPerMultiprocessor(&per_cu, (const void*)fwd_kernel, NWAVES * 64, LDS_BYTES) != hipSuccess || per_cu < 1) { fprintf(stderr, "kernel_launch: occupancy query says %d\n", per_cu); }
        (void)hipGetLastError();
        grid = cus;
    }
    if (grid < 0) return;
    (void)hipMemsetAsync((char*)d_ws + WS_CTL, 0, CTL_ZERO_BYTES, stream);
    Args a{};
    for (int i = 0; i < 28; ++i) a.in[i] = (const float*)d_in[i];
    a.out = (float*)d_out; a.ws = (unsigned char*)d_ws;
    hipLaunchKernelGGL(fwd_kernel, dim3(grid), dim3(NWAVES * 64), LDS_BYTES, stream, a);
}
```
